# Optimizing an MI355X kernel written in HIP

```python
import math
import jax, jax.numpy as jnp
from jax import lax
import numpy as np

D_MODEL = 2048
BATCH = 4
SEQ = 4096
DEPTH = 4

D_FF = 5632
D_HYENA = D_MODEL // 2
HYENA_ORDER = 2
SHORT_CONV = 3
FILTER_BANDS = 16
FILTER_EMB = 1 + 2 * FILTER_BANDS
FILTER_HIDDEN = 64
FILTER_INNER = 2
DECAY_FAST_PCT = 0.3
DECAY_SLOW_PCT = 1.5
DECAY_TARGET = 1e-2
N_DIRS = 2
D_SGU = D_MODEL // 2
SGU_CHUNK = 128
SGU_GROUPS = 8
N_BRANCH = 2
D_PROJ = (HYENA_ORDER + 1) * D_HYENA + 2 * D_SGU + N_BRANCH * D_MODEL
NORM_EPS = 1e-6
LN_EPS = 1e-5

kernel_name = "hybrid_hyena_gmlp_macaron_encoder"


def rms_norm(x, g):
    xf = x.astype(jnp.float32)
    y = xf * lax.rsqrt(jnp.mean(xf * xf, axis=-1, keepdims=True) + NORM_EPS)
    return (y * g.astype(jnp.float32)).astype(x.dtype)


def layer_norm(x, g, b):
    xf = x.astype(jnp.float32)
    mu = jnp.mean(xf, axis=-1, keepdims=True)
    var = jnp.mean(jnp.square(xf - mu), axis=-1, keepdims=True)
    y = (xf - mu) * lax.rsqrt(var + LN_EPS)
    return (y * g.astype(jnp.float32) + b.astype(jnp.float32)).astype(x.dtype)


def half_step_ffn(x, pre_g, w_gate, w_up, w_down, post_g):
    h = rms_norm(x, pre_g)
    h = (jax.nn.silu(h @ w_gate) * (h @ w_up)) @ w_down
    return x + 0.5 * rms_norm(h, post_g)


def centred_short_conv(u, w, b):
    L = u.shape[1]
    pad = SHORT_CONV // 2
    up = jnp.pad(u, ((0, 0), (pad, pad), (0, 0)))
    y = b
    for j in range(SHORT_CONV):
        y = y + up[:, j:j + L] * w[j]
    return y


def filter_positions(L):
    t = jnp.linspace(0.0, 1.0, L, dtype=jnp.float32)[:, None]
    w = (2.0 * math.pi / L) * jnp.arange(L, dtype=jnp.float32)[:, None]
    f = jnp.linspace(1e-4, FILTER_BANDS - 1, FILTER_BANDS, dtype=jnp.float32)[None, :]
    z = jnp.concatenate([t, jnp.cos(f * w), -jnp.sin(f * w)], axis=-1)
    return t, z


def implicit_filter_spectra(t, z, w1, b, freq, w_inner, w_out):
    L = z.shape[0]
    f32 = jnp.float32
    b = b.astype(f32)
    freq = freq.astype(f32)
    h = jnp.sin(freq[0] * (z @ w1.astype(f32) + b[0]))
    for j in range(FILTER_INNER):
        h = jnp.sin(freq[j + 1] * (h @ w_inner[j].astype(f32) + b[j + 1]))
    h = h @ w_out.astype(f32)
    max_decay = math.log(DECAY_TARGET) / DECAY_FAST_PCT
    min_decay = math.log(DECAY_TARGET) / DECAY_SLOW_PCT
    deltas = jnp.linspace(min_decay, max_decay, D_HYENA, dtype=f32)
    decay = jnp.exp(-t * jnp.abs(deltas)[None, :])
    h = h.reshape(L, HYENA_ORDER, N_DIRS, D_HYENA) * decay[:, None, None, :]
    h_fwd = h[:, :, 0]
    h_bwd = h[:, :, 1]
    k = jnp.concatenate([h_fwd, jnp.zeros_like(h_fwd[:1]), h_bwd[:0:-1]], axis=0)
    return jnp.fft.rfft(k, axis=0)


def long_conv(u, k_f, skip):
    L = u.shape[1]
    uf32 = u.astype(jnp.float32)
    uf = jnp.fft.rfft(uf32, n=2 * L, axis=1)
    y = jnp.fft.irfft(uf * k_f[None], n=2 * L, axis=1)[:, :L]
    return (y + uf32 * skip.astype(jnp.float32)).astype(u.dtype)


def hyena_mixer(proj, conv_w, conv_b, t, z, f_w1, f_b, f_freq, f_w_inner, f_w_out, skip):
    u = centred_short_conv(proj, conv_w, conv_b)
    parts = jnp.split(u, HYENA_ORDER + 1, axis=-1)
    y = parts[0]
    k_f = implicit_filter_spectra(t, z, f_w1, f_b, f_freq, f_w_inner, f_w_out)
    for o in range(HYENA_ORDER):
        y = parts[o + 1] * long_conv(y, k_f[:, o], skip[o])
    return y


def spatial_gating(proj, ln_g, ln_b, w_s, b_s):
    zz = jax.nn.gelu(proj)
    u, v = jnp.split(zz, 2, axis=-1)
    v = layer_norm(v, ln_g, ln_b)
    B, L, C = v.shape
    v = v.reshape(B, L // SGU_CHUNK, SGU_CHUNK, SGU_GROUPS, C // SGU_GROUPS)
    s = jnp.einsum('gts,bcsgd->bctgd', w_s, v) + b_s.T[None, None, :, :, None]
    return u * s.reshape(B, L, C)


def setup_inputs(seed: int = 0) -> dict:
    key = jax.random.key(seed)
    keys = iter(jax.random.split(key, 40))
    f32 = jnp.float32

    def nrm(shape, scale):
        return scale * jax.random.normal(next(keys), shape, f32)

    def gain(shape):
        return 1.0 + nrm(shape, 0.05)

    D, F, DH, DG = D_MODEL, D_FF, D_HYENA, D_SGU
    inp = {}
    inp["x"] = nrm((BATCH, SEQ, D), 1.0)
    inp["ffn1_pre_g"] = gain((DEPTH, D))
    inp["ffn1_w_gate"] = nrm((DEPTH, D, F), D ** -0.5)
    inp["ffn1_w_up"] = nrm((DEPTH, D, F), D ** -0.5)
    inp["ffn1_w_down"] = nrm((DEPTH, F, D), F ** -0.5)
    inp["ffn1_post_g"] = gain((DEPTH, D))
    inp["mix_pre_g"] = gain((DEPTH, D))
    inp["w_in"] = nrm((DEPTH, D, D_PROJ), D ** -0.5)
    inp["hy_conv_w"] = nrm((DEPTH, SHORT_CONV, (HYENA_ORDER + 1) * DH), SHORT_CONV ** -0.5)
    inp["hy_conv_b"] = nrm((DEPTH, (HYENA_ORDER + 1) * DH), 0.02)
    inp["filt_w1"] = nrm((DEPTH, FILTER_EMB, FILTER_HIDDEN), FILTER_EMB ** -0.5)
    inp["filt_b"] = nrm((DEPTH, FILTER_INNER + 1, FILTER_HIDDEN), 0.1)
    inp["filt_freq"] = gain((DEPTH, FILTER_INNER + 1, FILTER_HIDDEN))
    inp["filt_w_inner"] = nrm((DEPTH, FILTER_INNER, FILTER_HIDDEN, FILTER_HIDDEN), FILTER_HIDDEN ** -0.5)
    inp["filt_w_out"] = nrm((DEPTH, FILTER_HIDDEN, HYENA_ORDER * N_DIRS * DH), 0.02 * FILTER_HIDDEN ** -0.5)
    inp["hy_skip"] = nrm((DEPTH, HYENA_ORDER, DH), 1.0)
    inp["sgu_ln_g"] = gain((DEPTH, DG))
    inp["sgu_ln_b"] = nrm((DEPTH, DG), 0.02)
    inp["sgu_w_s"] = nrm((DEPTH, SGU_GROUPS, SGU_CHUNK, SGU_CHUNK), SGU_CHUNK ** -0.5)
    inp["sgu_b_s"] = gain((DEPTH, SGU_GROUPS, SGU_CHUNK))
    inp["p_a"] = nrm((DEPTH, DH, D), DH ** -0.5)
    inp["p_b"] = nrm((DEPTH, DG, D), DG ** -0.5)
    inp["w_out"] = nrm((DEPTH, D, D), D ** -0.5)
    inp["mix_post_g"] = gain((DEPTH, D))
    inp["ffn2_pre_g"] = gain((DEPTH, D))
    inp["ffn2_w_gate"] = nrm((DEPTH, D, F), D ** -0.5)
    inp["ffn2_w_up"] = nrm((DEPTH, D, F), D ** -0.5)
    inp["ffn2_w_down"] = nrm((DEPTH, F, D), F ** -0.5)
    inp["ffn2_post_g"] = gain((DEPTH, D))
    return inp


def reference(x, ffn1_pre_g, ffn1_w_gate, ffn1_w_up, ffn1_w_down, ffn1_post_g,
              mix_pre_g, w_in, hy_conv_w, hy_conv_b, filt_w1, filt_b, filt_freq,
              filt_w_inner, filt_w_out, hy_skip, sgu_ln_g, sgu_ln_b, sgu_w_s, sgu_b_s,
              p_a, p_b, w_out, mix_post_g,
              ffn2_pre_g, ffn2_w_gate, ffn2_w_up, ffn2_w_down, ffn2_post_g):
    L = x.shape[1]
    t, z = filter_positions(L)
    split_at = [(HYENA_ORDER + 1) * D_HYENA, (HYENA_ORDER + 1) * D_HYENA + 2 * D_SGU]
    for i in range(DEPTH):
        x = half_step_ffn(x, ffn1_pre_g[i], ffn1_w_gate[i], ffn1_w_up[i], ffn1_w_down[i], ffn1_post_g[i])
        n = rms_norm(x, mix_pre_g[i])
        proj = n @ w_in[i]
        hy_in, sg_in, gates = jnp.split(proj, split_at, axis=-1)
        a = hyena_mixer(hy_in, hy_conv_w[i], hy_conv_b[i], t, z, filt_w1[i], filt_b[i],
                        filt_freq[i], filt_w_inner[i], filt_w_out[i], hy_skip[i])
        b = spatial_gating(sg_in, sgu_ln_g[i], sgu_ln_b[i], sgu_w_s[i], sgu_b_s[i])
        g_a, g_b = jnp.split(gates, N_BRANCH, axis=-1)
        merged = jax.nn.sigmoid(g_a) * (a @ p_a[i]) + jax.nn.sigmoid(g_b) * (b @ p_b[i])
        x = x + rms_norm(merged @ w_out[i], mix_post_g[i])
        x = half_step_ffn(x, ffn2_pre_g[i], ffn2_w_gate[i], ffn2_w_up[i], ffn2_w_down[i], ffn2_post_g[i])
    return x
```

```cpp
#include <hip/hip_runtime.h>
#include <cstdio>
#include <cstdint>
#ifndef MK_SINGLE
#define MK_SINGLE 1
#endif
namespace pg8 {
#define PG8_LAS __attribute__((address_space(3)))
typedef unsigned short bf16_t;
typedef short bf16x8 __attribute__((ext_vector_type(8)));
typedef float f32x4 __attribute__((ext_vector_type(4)));
typedef unsigned u32x4 __attribute__((ext_vector_type(4)));
typedef unsigned u32x2 __attribute__((ext_vector_type(2)));
constexpr int BM = 256, BK = 64, HALF = 128, HTB = HALF * BK * 2  , STAGE_BYTES = 8 * HTB, NXCD = 8, WGM = 8;

__host__ __device__ __forceinline__ int lds_byte(int r, int c) { const int st = (r >> 4) * 2 + (c >> 5), rr = r & 15, cc = c & 31, ob = rr * 64 + cc * 2; return st * 1024 + (ob ^ (((ob >> 9) & 1) << 5)); }
__host__ __device__ __forceinline__ void stage_rc(int b, int& R, int& C) { const int st = b / 1024, sb = b % 1024, swz = sb ^ (((sb >> 9) & 1) << 5); R = (st >> 1) * 16 + swz / 64; C = (st & 1) * 32 + (swz % 64) / 2; }
__host__ __device__ __forceinline__ int perm32(int rho) { const int n = rho >> 4, i = rho & 15; return 8 * (i >> 2) + 4 * n + (i & 3); }

struct Unit { int pm, pn; };
struct Gemm { const bf16_t* A; const bf16_t* Bt; int M, N, K; };

struct StaticOrder {
    int nM, nN, nwg, G, c;
    __host__ __device__ void init(int M, int N, int G_, int c_) { nM = M / BM; nN = N / BM; nwg = nM * nN; G = G_; c = c_; }
    __host__ __device__ bool next(int i, Unit& u) const {
        const long L = (long)i * G + c; if (L >= nwg) return false;
        int wgid = (int)L; { const int q = nwg / NXCD, r = nwg % NXCD, xcd = wgid % NXCD, off = wgid / NXCD; wgid = (xcd < r ? xcd * (q + 1) : r * (q + 1) + (xcd - r) * q) + off; }
        const int nig = WGM * nN, gid = wgid / nig, fm = gid * WGM, gsz = (nM - fm) < WGM ? (nM - fm) : WGM;
        u.pm = fm + ((wgid % nig) % gsz); u.pn = (wgid % nig) / gsz; return true;
    }
    __device__ __forceinline__ void a_ready(const Unit&) const {}
    __device__ __forceinline__ void done(const Unit&) const {}
};

__device__ __forceinline__ unsigned cvt_pk_bf16(float lo, float hi) { unsigned r; asm volatile("v_cvt_pk_bf16_f32 %0, %1, %2" : "=v"(r) : "v"(lo), "v"(hi)); return r; }
__device__ __forceinline__ float bf_lo(unsigned w) { return __uint_as_float(w << 16); }
__device__ __forceinline__ float bf_hi(unsigned w) { return __uint_as_float(w & 0xffff0000u); }
__device__ __forceinline__ float sigmoid_f(float x) { return __builtin_amdgcn_rcpf(1.0f + __builtin_amdgcn_exp2f(-1.4426950408889634f * x)); }
__device__ __forceinline__ float silu_f(float x) { return x * sigmoid_f(x); }
__device__ __forceinline__ float gelu_tanh_f(float x) { const float u2 = 1.5957691216057308f * (x + 0.044715f * x * x * x); return x * sigmoid_f(u2); }

struct EpiF32 {
    static constexpr bool PERM = false, AFTER_DRAIN = false;
    float* C; int ldc;
    __device__ __forceinline__ void operator()(const f32x4 (&acc)[2][2][4][2], const Unit& u, int wr, int wc, int fr, int fq) const {
        const int row0 = u.pm * BM + wr * 64 + fr, col0 = u.pn * BM + wc * 32 + 4 * fq;
#pragma unroll
        for (int ai = 0; ai < 2; ++ai)
#pragma unroll
            for (int m = 0; m < 4; ++m) { float* rowp = C + (size_t)(row0 + ai * HALF + m * 16) * ldc + col0;
#pragma unroll
                for (int bj = 0; bj < 2; ++bj)
#pragma unroll
                    for (int n = 0; n < 2; ++n) *(f32x4*)(rowp + bj * HALF + n * 16) = acc[ai][bj][m][n]; }
    }
};
struct EpiBf16 {
    static constexpr bool PERM = true, AFTER_DRAIN = false;
    bf16_t* O; int ldc;
    __device__ __forceinline__ void operator()(const f32x4 (&acc)[2][2][4][2], const Unit& u, int wr, int wc, int fr, int fq) const {
        const int row0 = u.pm * BM + wr * 64 + fr, col0 = u.pn * BM + wc * 32 + 8 * fq;
#pragma unroll
        for (int ai = 0; ai < 2; ++ai)
#pragma unroll
            for (int m = 0; m < 4; ++m) { bf16_t* rowp = O + (size_t)(row0 + ai * HALF + m * 16) * ldc + col0;
#pragma unroll
                for (int bj = 0; bj < 2; ++bj) { const f32x4 v0 = acc[ai][bj][m][0], v1 = acc[ai][bj][m][1];
                    u32x4 w; w.x = cvt_pk_bf16(v0[0], v0[1]); w.y = cvt_pk_bf16(v0[2], v0[3]); w.z = cvt_pk_bf16(v1[0], v1[1]); w.w = cvt_pk_bf16(v1[2], v1[3]);
                    *(u32x4*)(rowp + bj * HALF) = w; } }
    }
};
struct EpiSwiGLU {
    static constexpr bool PERM = true, AFTER_DRAIN = false;
    bf16_t* O; int ldc;
    __device__ __forceinline__ void operator()(const f32x4 (&acc)[2][2][4][2], const Unit& u, int wr, int wc, int fr, int fq) const {
        const int row0 = u.pm * BM + wr * 64 + fr, col0 = u.pn * HALF + wc * 32 + 8 * fq;
#pragma unroll
        for (int ai = 0; ai < 2; ++ai)
#pragma unroll
            for (int m = 0; m < 4; ++m) { bf16_t* rowp = O + (size_t)(row0 + ai * HALF + m * 16) * ldc + col0;
                const f32x4 g0 = acc[ai][0][m][0], g1 = acc[ai][0][m][1], u0 = acc[ai][1][m][0], u1 = acc[ai][1][m][1];
                u32x4 w; w.x = cvt_pk_bf16(silu_f(g0[0]) * u0[0], silu_f(g0[1]) * u0[1]); w.y = cvt_pk_bf16(silu_f(g0[2]) * u0[2], silu_f(g0[3]) * u0[3]);
                w.z = cvt_pk_bf16(silu_f(g1[0]) * u1[0], silu_f(g1[1]) * u1[1]); w.w = cvt_pk_bf16(silu_f(g1[2]) * u1[2], silu_f(g1[3]) * u1[3]);
                *(u32x4*)rowp = w; }
    }
};
struct EpiWinRest {
    static constexpr bool PERM = true, AFTER_DRAIN = false;
    bf16_t* ZZ; bf16_t* GT;
    __device__ __forceinline__ void operator()(const f32x4 (&acc)[2][2][4][2], const Unit& u, int wr, int wc, int fr, int fq) const {
        const bool is_gate = u.pn >= 8;
        bf16_t* base = is_gate ? GT : ZZ; const int ldc = is_gate ? 4096 : 2048;
        const int row0 = u.pm * BM + wr * 64 + fr, col0 = (is_gate ? u.pn - 8 : u.pn) * BM + wc * 32 + 8 * fq;
#pragma unroll
        for (int ai = 0; ai < 2; ++ai)
#pragma unroll
            for (int m = 0; m < 4; ++m) { bf16_t* rowp = base + (size_t)(row0 + ai * HALF + m * 16) * ldc + col0;
#pragma unroll
                for (int bj = 0; bj < 2; ++bj) { f32x4 v0 = acc[ai][bj][m][0], v1 = acc[ai][bj][m][1];
                    if (is_gate) {
#pragma unroll
                        for (int j = 0; j < 4; ++j) { v0[j] = sigmoid_f(v0[j]); v1[j] = sigmoid_f(v1[j]); }
                    } else {
#pragma unroll
                        for (int j = 0; j < 4; ++j) { v0[j] = gelu_tanh_f(v0[j]); v1[j] = gelu_tanh_f(v1[j]); }
                    }
                    u32x4 w; w.x = cvt_pk_bf16(v0[0], v0[1]); w.y = cvt_pk_bf16(v0[2], v0[3]); w.z = cvt_pk_bf16(v1[0], v1[1]); w.w = cvt_pk_bf16(v1[2], v1[3]);
                    *(u32x4*)(rowp + bj * HALF) = w; } }
    }
};
struct EpiPA {
    static constexpr bool PERM = false, AFTER_DRAIN = false;
    float* T1; const bf16_t* GT;
    __device__ __forceinline__ void operator()(const f32x4 (&acc)[2][2][4][2], const Unit& u, int wr, int wc, int fr, int fq) const {
        const int row0 = u.pm * BM + wr * 64 + fr, col0 = u.pn * BM + wc * 32 + 4 * fq;
#pragma unroll
        for (int ai = 0; ai < 2; ++ai)
#pragma unroll
            for (int m = 0; m < 4; ++m) { const size_t r = (size_t)(row0 + ai * HALF + m * 16);
#pragma unroll
                for (int bj = 0; bj < 2; ++bj)
#pragma unroll
                    for (int n = 0; n < 2; ++n) { const int c = col0 + bj * HALF + n * 16; const u32x2 g = *(const u32x2*)(GT + r * 4096 + c);
                        const f32x4 a = acc[ai][bj][m][n]; f32x4 o; o[0] = a[0] * bf_lo(g.x); o[1] = a[1] * bf_hi(g.x); o[2] = a[2] * bf_lo(g.y); o[3] = a[3] * bf_hi(g.y);
                        *(f32x4*)(T1 + r * 2048 + c) = o; } }
    }
};
struct EpiPB {
    static constexpr bool PERM = false, AFTER_DRAIN = false;
    const float* T1; const bf16_t* GT; bf16_t* MG;
    __device__ __forceinline__ void operator()(const f32x4 (&acc)[2][2][4][2], const Unit& u, int wr, int wc, int fr, int fq) const {
        const int row0 = u.pm * BM + wr * 64 + fr, col0 = u.pn * BM + wc * 32 + 4 * fq;
#pragma unroll
        for (int ai = 0; ai < 2; ++ai)
#pragma unroll
            for (int m = 0; m < 4; ++m) { const size_t r = (size_t)(row0 + ai * HALF + m * 16);
#pragma unroll
                for (int bj = 0; bj < 2; ++bj)
#pragma unroll
                    for (int n = 0; n < 2; ++n) { const int c = col0 + bj * HALF + n * 16; const u32x2 g = *(const u32x2*)(GT + r * 4096 + 2048 + c);
                        const f32x4 t = *(const f32x4*)(T1 + r * 2048 + c); const f32x4 a = acc[ai][bj][m][n];
                        u32x2 w; w.x = cvt_pk_bf16(t[0] + a[0] * bf_lo(g.x), t[1] + a[1] * bf_hi(g.x)); w.y = cvt_pk_bf16(t[2] + a[2] * bf_lo(g.y), t[3] + a[3] * bf_hi(g.y));
                        *(u32x2*)(MG + r * 2048 + c) = w; } }
    }
};

template <class Epi, class Sched, bool ALIGN_EPI = false, bool SP2 = false>
__device__ __forceinline__ void gemm_phase(PG8_LAS unsigned char* lds, const Gemm g, const Sched& S, const Epi& E) {
    int tid_o = threadIdx.x; asm volatile("" : "+v"(tid_o));
    const int tid = tid_o, wid = __builtin_amdgcn_readfirstlane(tid >> 6), lane = tid & 63, wr = wid >> 2, wc = wid & 3, fr = lane & 15, fq = lane >> 4;
    const int K = g.K, nt = K / BK;
    unsigned voffA[2], voffB[2];
#pragma unroll
    for (int i = 0; i < 2; ++i) { int R, C; stage_rc(tid * 16 + i * 8192, R, C); const int Rb = Epi::PERM ? ((R & ~31) + perm32(R & 31)) : R;
        voffA[i] = (unsigned)(R * K + C) * 2u; voffB[i] = (unsigned)(Rb * K + C) * 2u; }
    const size_t kstep = (size_t)(BK * 2);
    const size_t hstep = (size_t)HALF * K * 2;
    const size_t tstep = 2 * hstep;
    const unsigned ldsw = (unsigned)wid * 1024u;
    const int aoff = lds_byte(wr * 64 + fr, fq * 8), boff = lds_byte(wc * 32 + fr, fq * 8);
#define PG8_SA(b, h) (((b) * 2 + (h)) * HTB)
#define PG8_SB(b, h) ((4 + (b) * 2 + (h)) * HTB)
#define PG8_STAGE(bufoff, gbase, voff) do { _Pragma("unroll") for (int _i = 0; _i < 2; ++_i) \
        __builtin_amdgcn_global_load_lds((const unsigned*)((const char*)(gbase) + (voff)[_i]), (PG8_LAS unsigned*)(lds + (bufoff) + ldsw + _i * 8192), 16, 0, 0); } while (0)
#define PG8_LDA(dst, b, h) do { _Pragma("unroll") for (int m = 0; m < 4; ++m) _Pragma("unroll") for (int k = 0; k < 2; ++k) dst[m][k] = *(const PG8_LAS bf16x8*)(lds + PG8_SA(b, h) + aoff + m * 2048 + k * 1024); } while (0)
#define PG8_LDB(dst, b, h) do { _Pragma("unroll") for (int n = 0; n < 2; ++n) _Pragma("unroll") for (int k = 0; k < 2; ++k) dst[n][k] = *(const PG8_LAS bf16x8*)(lds + PG8_SB(b, h) + boff + n * 2048 + k * 1024); } while (0)
#define PG8_MMA(ai, bj, At, Bt) do { __builtin_amdgcn_s_setprio(1); _Pragma("unroll") for (int m = 0; m < 4; ++m) _Pragma("unroll") for (int n = 0; n < 2; ++n) _Pragma("unroll") for (int k = 0; k < 2; ++k) \
        acc[ai][bj][m][n] = __builtin_amdgcn_mfma_f32_16x16x32_bf16(Bt[n][k], At[m][k], acc[ai][bj][m][n], 0, 0, 0); __builtin_amdgcn_s_setprio(0); } while (0)
#define PG8_WAIT_V(n) asm volatile("s_waitcnt vmcnt(" #n ")" ::: "memory")
#define PG8_WAIT_L(n) asm volatile("s_waitcnt lgkmcnt(" #n ")" ::: "memory")
#define PG8_BAR __builtin_amdgcn_s_barrier()
#define PG8_SCHED __builtin_amdgcn_sched_barrier(0)
    Unit cur, nxt; int ui = 0;
    if (!S.next(0, cur)) return;
    f32x4 acc[2][2][4][2];
#pragma unroll
    for (int a = 0; a < 2; ++a)
#pragma unroll
        for (int b = 0; b < 2; ++b)
#pragma unroll
            for (int m = 0; m < 4; ++m)
#pragma unroll
                for (int n = 0; n < 2; ++n) acc[a][b][m][n] = (f32x4){0.f, 0.f, 0.f, 0.f};
    bf16x8 At[4][2], B0[2][2], B1[2][2];
    const char* cA = (const char*)g.A + (size_t)cur.pm * tstep; const char* cB = (const char*)g.Bt + (size_t)cur.pn * tstep;
    S.a_ready(cur);
    if constexpr (SP2) {
        PG8_STAGE(PG8_SB(0, 0), cB, voffB); PG8_STAGE(PG8_SB(0, 1), cB + hstep, voffB); PG8_STAGE(PG8_SA(0, 0), cA, voffA); PG8_STAGE(PG8_SA(0, 1), cA + hstep, voffA);
        if (wr == 1) PG8_BAR;
        PG8_WAIT_V(2); PG8_BAR;
        PG8_STAGE(PG8_SB(1, 0), cB + kstep, voffB); PG8_STAGE(PG8_SA(1, 0), cA + kstep, voffA); PG8_STAGE(PG8_SB(1, 1), cB + hstep + kstep, voffB);
        PG8_WAIT_V(6); PG8_BAR;
    } else {
        PG8_STAGE(PG8_SB(0, 0), cB, voffB); PG8_STAGE(PG8_SA(0, 0), cA, voffA); PG8_STAGE(PG8_SB(0, 1), cB + hstep, voffB); PG8_STAGE(PG8_SA(0, 1), cA + hstep, voffA);
        if (wr == 1) PG8_BAR;
        PG8_WAIT_V(4); PG8_BAR;
        PG8_STAGE(PG8_SB(1, 0), cB + kstep, voffB); PG8_STAGE(PG8_SA(1, 0), cA + kstep, voffA); PG8_STAGE(PG8_SB(1, 1), cB + hstep + kstep, voffB);
        PG8_WAIT_V(6); PG8_BAR;
    }
    for (;;) {
        const bool has_next = S.next(ui + 1, nxt);
        const char* nA = has_next ? (const char*)g.A + (size_t)nxt.pm * tstep : cA; const char* nB = has_next ? (const char*)g.Bt + (size_t)nxt.pn * tstep : cB;
        for (int t = 0; t < nt; t += 2) {
            const bool last = (t == nt - 2);
            const char* a1 = cA + (size_t)(t + 1) * kstep;
            const char* a2 = last ? nA : cA + (size_t)(t + 2) * kstep; const char* b2 = last ? nB : cB + (size_t)(t + 2) * kstep;
            const char* a3 = a2 + kstep; const char* b3 = b2 + kstep;
            if (last && has_next) S.a_ready(nxt);
            if constexpr (SP2) {
            PG8_LDB(B0, 0, 0); PG8_LDB(B1, 0, 1); PG8_SCHED; PG8_LDA(At, 0, 0); PG8_STAGE(PG8_SA(1, 1), a1 + hstep, voffA);
            PG8_WAIT_V(8); PG8_WAIT_L(0); PG8_BAR; PG8_MMA(0, 0, At, B0); PG8_MMA(0, 1, At, B1); PG8_BAR; PG8_SCHED;
            PG8_LDA(At, 0, 1); PG8_STAGE(PG8_SB(0, 0), b2, voffB); PG8_STAGE(PG8_SB(0, 1), b2 + hstep, voffB); PG8_STAGE(PG8_SA(0, 0), a2, voffA);
            PG8_WAIT_V(8); PG8_WAIT_L(0); PG8_BAR; PG8_MMA(1, 0, At, B0); PG8_MMA(1, 1, At, B1); PG8_BAR; PG8_SCHED;
            PG8_LDB(B0, 1, 0); PG8_LDB(B1, 1, 1); PG8_SCHED; PG8_LDA(At, 1, 0); PG8_STAGE(PG8_SA(0, 1), a2 + hstep, voffA);
            PG8_WAIT_V(8); PG8_WAIT_L(0); PG8_BAR; PG8_MMA(0, 0, At, B0); PG8_MMA(0, 1, At, B1); PG8_BAR; PG8_SCHED;
            PG8_LDA(At, 1, 1); PG8_STAGE(PG8_SB(1, 0), b3, voffB); PG8_STAGE(PG8_SB(1, 1), b3 + hstep, voffB); PG8_STAGE(PG8_SA(1, 0), a3, voffA);
            PG8_WAIT_V(8); PG8_WAIT_L(0); PG8_BAR; PG8_MMA(1, 0, At, B0); PG8_MMA(1, 1, At, B1); PG8_BAR; PG8_SCHED;
            } else {
            PG8_LDB(B0, 0, 0); PG8_SCHED; PG8_LDA(At, 0, 0); PG8_STAGE(PG8_SA(1, 1), a1 + hstep, voffA);
            PG8_WAIT_L(8); PG8_BAR; PG8_WAIT_L(0); PG8_MMA(0, 0, At, B0); PG8_BAR; PG8_SCHED;
            PG8_LDB(B1, 0, 1); PG8_STAGE(PG8_SB(0, 0), b2, voffB);
            PG8_BAR; PG8_WAIT_L(0); PG8_MMA(0, 1, At, B1); PG8_BAR;
            PG8_LDA(At, 0, 1); PG8_STAGE(PG8_SA(0, 0), a2, voffA);
            PG8_BAR; PG8_WAIT_L(0); PG8_MMA(1, 0, At, B0); PG8_BAR; PG8_SCHED;
            PG8_STAGE(PG8_SB(0, 1), b2 + hstep, voffB);
            PG8_WAIT_V(6); PG8_BAR; PG8_MMA(1, 1, At, B1); PG8_BAR;
            PG8_LDB(B0, 1, 0); PG8_SCHED; PG8_LDA(At, 1, 0); PG8_STAGE(PG8_SA(0, 1), a2 + hstep, voffA);
            PG8_WAIT_L(8); PG8_BAR; PG8_WAIT_L(0); PG8_MMA(0, 0, At, B0); PG8_BAR; PG8_SCHED;
            PG8_LDB(B1, 1, 1); PG8_STAGE(PG8_SB(1, 0), b3, voffB);
            PG8_BAR; PG8_WAIT_L(0); PG8_MMA(0, 1, At, B1); PG8_BAR;
            PG8_LDA(At, 1, 1); PG8_STAGE(PG8_SA(1, 0), a3, voffA);
            PG8_BAR; PG8_WAIT_L(0); PG8_MMA(1, 0, At, B0); PG8_BAR; PG8_SCHED;
            PG8_STAGE(PG8_SB(1, 1), b3 + hstep, voffB);
            PG8_WAIT_V(6); PG8_BAR; PG8_MMA(1, 1, At, B1); PG8_BAR;
            }
        }
        if constexpr (ALIGN_EPI) { if (wr == 0) PG8_BAR; }
        if constexpr (!Epi::AFTER_DRAIN) { E(acc, cur, wr, wc, fr, fq); S.done(cur); }
        if (!has_next) break;
#pragma unroll
        for (int a = 0; a < 2; ++a)
#pragma unroll
            for (int b = 0; b < 2; ++b)
#pragma unroll
                for (int m = 0; m < 4; ++m)
#pragma unroll
                    for (int n = 0; n < 2; ++n) acc[a][b][m][n] = (f32x4){0.f, 0.f, 0.f, 0.f};
        cur = nxt; cA = nA; cB = nB; ++ui;
        if constexpr (ALIGN_EPI) { if (wr == 1) PG8_BAR; }
    }
    PG8_WAIT_V(0);
    if constexpr (!ALIGN_EPI) { if (wr == 0) PG8_BAR; }
    PG8_BAR;
    if constexpr (Epi::AFTER_DRAIN) { E.fused(acc, cur, wr, wc, fr, fq, lds, wid, lane); S.done(cur); }
#undef PG8_SA
#undef PG8_SB
#undef PG8_STAGE
#undef PG8_LDA
#undef PG8_LDB
#undef PG8_MMA
#undef PG8_WAIT_V
#undef PG8_WAIT_L
#undef PG8_BAR
#undef PG8_SCHED
}
}

constexpr int BATCH = 4, SEQ = 4096, D = 2048, FF = 5632, DH = 1024, DG = 1024, DEPTH = 4, M = BATCH * SEQ;
constexpr int DPROJ = 9216, NHY = 3072;
constexpr int NWAVES = 8;
constexpr int NPH = 1 + 11 * DEPTH;
constexpr size_t MiB = 1u << 20;
constexpr size_t WS_CTL = 0, CTL_ZERO_BYTES = 1 * MiB;
constexpr size_t WS_HID = 1 * MiB;
constexpr size_t WS_W = 8 * MiB;
constexpr size_t LAYER_W = 96468992;
constexpr size_t OFF_GU1 = 0, OFF_D1 = 23068672, OFF_WIN = 34603008, OFF_PA = 53477376, OFF_PB = 55574528, OFF_WO = 57671680, OFF_GU2 = 61865984, OFF_D2 = 84934656;
constexpr size_t WS_NB = 744 * MiB;
constexpr size_t WS_HB = 808 * MiB;
constexpr size_t WS_PT = 808 * MiB;
constexpr size_t WS_ZZ = 904 * MiB;
constexpr size_t WS_HD = 984 * MiB;
constexpr size_t WS_GT = 1112 * MiB;
constexpr size_t WS_A = 1240 * MiB, WS_B = 1272 * MiB;
constexpr size_t WS_MG = 1304 * MiB;
constexpr size_t WS_TAPS = 1368 * MiB;
constexpr size_t WS_END = 1432 * MiB;
static_assert(WS_W + 4 * LAYER_W * 2 <= WS_NB && WS_ZZ + (size_t)M * 2048 * 2 <= WS_HD && WS_HB + (size_t)M * FF * 2 <= WS_HD, "ws map");
constexpr int CW_BAR = 4096;
constexpr int RING_BYTES = 131072, MISC_OFF = 133120, LDS_BYTES = MISC_OFF + 256;

#define GAS __attribute__((address_space(1)))
#define LAS __attribute__((address_space(3)))
typedef unsigned short bf16;
typedef float f32x4 __attribute__((ext_vector_type(4)));
typedef short bf16x8 __attribute__((ext_vector_type(8)));
typedef unsigned u32x4 __attribute__((ext_vector_type(4)));
typedef unsigned u32x2 __attribute__((ext_vector_type(2)));
#define LDS_WAIT() asm volatile("s_waitcnt lgkmcnt(0)" ::: "memory")
__device__ __forceinline__ unsigned f2bf(float f) { unsigned u = __builtin_bit_cast(unsigned, f); return (u + 0x7fffu + ((u >> 16) & 1u)) >> 16; }
__device__ __forceinline__ unsigned pk2(float lo, float hi) { return f2bf(lo) | (f2bf(hi) << 16); }
__device__ __forceinline__ float bf2f(bf16 b) { return __uint_as_float(((unsigned)b) << 16); }
__device__ __forceinline__ float wave_sum(float v) {
#pragma unroll
    for (int o = 1; o < 64; o <<= 1) v += __shfl_xor(v, o);
    return v;
}
__device__ __forceinline__ float sin_rad(float x) { return __builtin_amdgcn_sinf(__builtin_amdgcn_fractf(x * 0.15915494309189535f)); }

#define XB_TMO      128
#define XB_XCNT(j)  (256  + 64 * (j))
#define XB_XSUB(j)  (1280 + 64 * (j))
#define XB_XGEN(j)  (2304 + 64 * (j))
#define XB_TOP      3328
#define XB_TOPGEN   3392
#define XCD_BAR_WORDS 3456
#define XB_SPIN_CAP (1u << 18)
__device__ __forceinline__ unsigned xb_ld(unsigned* p)              { return __hip_atomic_load(p, __ATOMIC_RELAXED, __HIP_MEMORY_SCOPE_AGENT); }
__device__ __forceinline__ unsigned xb_add(unsigned* p, unsigned v) { return __hip_atomic_fetch_add(p, v, __ATOMIC_RELAXED, __HIP_MEMORY_SCOPE_AGENT); }
__device__ __forceinline__ unsigned xb_xcc_id() { return (unsigned)__builtin_amdgcn_s_getreg((3 << 11) | 20) & 0xFu; }
#define XB_SPIN(cond, bar) do { unsigned _sp = 0; while (cond) { __builtin_amdgcn_s_sleep(1); \
    if ((++_sp & 255u) == 0u) { if (xb_ld(&(bar)[XB_TMO])) break; if (_sp > XB_SPIN_CAP) { atomicAdd(&(bar)[XB_TMO], 1u); break; } } } } while (0)
struct XcdBarrier { unsigned* bar; unsigned x; volatile LAS unsigned* st; };
__device__ __forceinline__ XcdBarrier xcd_barrier_post(unsigned* bar, volatile LAS unsigned* st) {
    XcdBarrier b; b.bar = bar; b.x = xb_xcc_id(); b.st = st;
    if (threadIdx.x == 0) (void)xb_add(&bar[XB_XCNT(b.x)], 1u);
    return b;
}
__device__ __forceinline__ void xcd_barrier_complete(unsigned* bar, unsigned x, unsigned& nloc, unsigned& nx) {
    const unsigned G = gridDim.x * gridDim.y * gridDim.z;
    unsigned sum, cnt, mine, sp = 0u;
    for (;;) {
        sum = 0u; cnt = 0u; mine = 0u;
#pragma unroll
        for (unsigned j = 0; j < 16; ++j) { const unsigned c = xb_ld(&bar[XB_XCNT(j)]); sum += c; cnt += (c > 0u) ? 1u : 0u; mine = (j == x) ? c : mine; }
        if (sum == G) break;
        __builtin_amdgcn_s_sleep(1);
        if ((++sp & 255u) == 0u) { if (xb_ld(&bar[XB_TMO])) break; if (sp > XB_SPIN_CAP) { atomicAdd(&bar[XB_TMO], 1u); break; } }
    }
    nloc = mine > 0u ? mine : 1u; nx = cnt > 0u ? cnt : 1u;
}
__device__ __forceinline__ void xcd_barrier(const XcdBarrier& b) {
    asm volatile("s_waitcnt vmcnt(0)" ::: "memory");
    __syncthreads();
    if (threadIdx.x == 0) {
        unsigned* bar = b.bar;
        __builtin_amdgcn_s_waitcnt(0);
        unsigned nloc = b.st[0], nx = b.st[1];
        if (nloc == 0u) { xcd_barrier_complete(bar, b.x, nloc, nx); b.st[0] = nloc; b.st[1] = nx; }
        const unsigned old = xb_add(&bar[XB_XSUB(b.x)], 1u);
        const unsigned gen = old / nloc;
        if (old + 1u == (gen + 1u) * nloc) {
            __builtin_amdgcn_fence(__ATOMIC_RELEASE, "agent");
            asm volatile("s_waitcnt vmcnt(0)" ::: "memory");
            const unsigned og = xb_add(&bar[XB_TOP], 1u);
            const unsigned tg = og / nx;
            if (og + 1u == (tg + 1u) * nx) xb_add(&bar[XB_TOPGEN], 1u);
            else XB_SPIN(xb_ld(&bar[XB_TOPGEN]) == tg, bar);
            __builtin_amdgcn_fence(__ATOMIC_ACQUIRE, "agent");
            xb_add(&bar[XB_XGEN(b.x)], 1u);
            asm volatile("s_waitcnt vmcnt(0)" ::: "memory");
        } else {
            XB_SPIN(xb_ld(&bar[XB_XGEN(b.x)]) == gen, bar);
            __builtin_amdgcn_fence(__ATOMIC_ACQUIRE, "agent");
            asm volatile("s_waitcnt vmcnt(0)" ::: "memory");
        }
    }
    __syncthreads();
}

#define FFT_DEV __device__ __forceinline__
#define FFT_LDS LAS
#define FFT_PIN(a, b) asm volatile("" : "+v"(a), "+v"(b))
#define FFT_DEVICE_LD 1
typedef float f32x2v __attribute__((ext_vector_type(2)));
#define FFT_XPTR LAS f32x2v*
#define FFT_LD(X, i) fft_ld_((X), (i))
#define FFT_ST(X, i, v) ((X)[i] = (f32x2v){(v).x, (v).y})
#define FFT_COS_REV(f) __builtin_amdgcn_cosf(f)
#define FFT_SIN_REV(f) __builtin_amdgcn_sinf(f)
struct cf { float x, y; };
#ifdef FFT_DEVICE_LD
FFT_DEV cf fft_ld_(FFT_XPTR X, int i) { const f32x2v t = X[i]; return cf{t.x, t.y}; }
#endif
FFT_DEV cf cmul(cf a, cf b) { return cf{a.x * b.x - a.y * b.y, a.x * b.y + a.y * b.x}; }
FFT_DEV cf cmulc(cf a, cf b) { return cf{a.x * b.x + a.y * b.y, a.y * b.x - a.x * b.y}; }
FFT_DEV cf W_rev(float f) { return cf{FFT_COS_REV(f), -FFT_SIN_REV(f)}; }
FFT_DEV float c16c(int m) { return m == 0 ? 1.f : m == 1 ? 0.92387953251f : m == 2 ? 0.70710678118f : m == 3 ? 0.38268343236f : m == 4 ? 0.f : m == 5 ? -0.38268343236f : m == 6 ? -0.70710678118f : -0.92387953251f; }
FFT_DEV float c16s(int m) { return m == 0 ? 0.f : m == 1 ? 0.38268343236f : m == 2 ? 0.70710678118f : m == 3 ? 0.92387953251f : m == 4 ? 1.f : m == 5 ? 0.92387953251f : m == 6 ? 0.70710678118f : 0.38268343236f; }
template <int R, bool NOTW> FFT_DEV void grp_fwd(cf (&v)[1 << R], float theta) {
    cf wp = NOTW ? cf{1.f, 0.f} : W_rev(theta);
#pragma unroll
    for (int j = 0; j < R; ++j) {
        const int span = 1 << (R - 1 - j);
#pragma unroll
        for (int e0 = 0; e0 < (1 << R); ++e0) {
            if (e0 & span) continue;
            const int e1 = e0 + span, el = e0 & (span - 1), m = el * (8 / span);
            const cf cw = cf{c16c(m), -c16s(m)};
            const cf a = v[e0], b = v[e1];
            const cf d = cf{a.x - b.x, a.y - b.y};
            v[e0] = cf{a.x + b.x, a.y + b.y};
            if (NOTW) v[e1] = (m == 0) ? d : cmul(d, cw);
            else v[e1] = (m == 0) ? cmul(d, wp) : cmul(d, cmul(cw, wp));
        }
        if (!NOTW) wp = cmul(wp, wp);
    }
}
template <int R, bool NOTW> FFT_DEV void grp_inv(cf (&v)[1 << R], float theta) {
    cf wps[R];
    wps[0] = NOTW ? cf{1.f, 0.f} : W_rev(theta);
#pragma unroll
    for (int j = 1; j < R; ++j) wps[j] = NOTW ? cf{1.f, 0.f} : cmul(wps[j - 1], wps[j - 1]);
#pragma unroll
    for (int j = R - 1; j >= 0; --j) {
        const int span = 1 << (R - 1 - j);
#pragma unroll
        for (int e0 = 0; e0 < (1 << R); ++e0) {
            if (e0 & span) continue;
            const int e1 = e0 + span, el = e0 & (span - 1), m = el * (8 / span);
            const cf cw = cf{c16c(m), -c16s(m)};
            cf bp;
            if (NOTW) bp = (m == 0) ? v[e1] : cmulc(v[e1], cw);
            else bp = (m == 0) ? cmulc(v[e1], wps[j]) : cmulc(v[e1], cmul(cw, wps[j]));
            const cf a = v[e0];
            v[e0] = cf{a.x + bp.x, a.y + bp.y};
            v[e1] = cf{a.x - bp.x, a.y - bp.y};
        }
    }
}
FFT_DEV int fphys(int i) { return i + (i >> 5); }
constexpr int FFT_SLOTS = 8192 + 256;
template <int S0, int R, bool INV> FFT_DEV void pass_lds(FFT_XPTR X, int tid) {
    constexpr int STRIDE = 1 << (13 - S0 - R), NG = 8192 >> R;
#pragma unroll 1
    for (int g = tid; g < NG; g += 512) {
        const int lo = g & (STRIDE - 1), hi = g / STRIDE, base = hi * (STRIDE << R) + lo;
        int pb = fphys(base);
        float th = (float)lo * (1.0f / (float)(STRIDE << R));
        FFT_PIN(pb, th);
        cf v[1 << R];
#pragma unroll
        for (int e = 0; e < (1 << R); ++e) v[e] = FFT_LD(X, pb + (e * STRIDE + ((e * STRIDE) >> 5)));
        if (INV) grp_inv<R, false>(v, th); else grp_fwd<R, false>(v, th);
#pragma unroll
        for (int e = 0; e < (1 << R); ++e) FFT_ST(X, pb + (e * STRIDE + ((e * STRIDE) >> 5)), v[e]);
    }
}
FFT_DEV void pass1_fwd_store(FFT_XPTR X, int tid, cf (&v)[16]) {
    int pb = fphys(tid); float th = (float)tid * (1.0f / 8192.0f);
    FFT_PIN(pb, th);
    grp_fwd<4, false>(v, th);
#pragma unroll
    for (int e = 0; e < 16; ++e) FFT_ST(X, pb + 528 * e, v[e]);
}
FFT_DEV void pass1_inv_load(FFT_XPTR X, int tid, cf (&v)[16]) {
    int pb = fphys(tid); float th = (float)tid * (1.0f / 8192.0f);
    FFT_PIN(pb, th);
#pragma unroll
    for (int e = 0; e < 16; ++e) v[e] = FFT_LD(X, pb + 528 * e);
    grp_inv<4, false>(v, th);
}
template <bool KEEP> FFT_DEV void pass4(FFT_XPTR X, int tid, cf (&Kr)[2][8]) {
#pragma unroll
    for (int q = 0; q < 2; ++q) {
        int pb = fphys((tid + 512 * q) * 8); float dummy = 0.f;
        FFT_PIN(pb, dummy);
        cf v[8];
#pragma unroll
        for (int e = 0; e < 8; ++e) v[e] = FFT_LD(X, pb + e);
        grp_fwd<3, true>(v, 0.f);
        if (KEEP) {
#pragma unroll
            for (int e = 0; e < 8; ++e) Kr[q][e] = v[e];
        } else {
#pragma unroll
            for (int e = 0; e < 8; ++e) v[e] = cmul(v[e], Kr[q][e]);
            grp_inv<3, true>(v, 0.f);
#pragma unroll
            for (int e = 0; e < 8; ++e) FFT_ST(X, pb + e, v[e]);
        }
    }
}

struct Args { const float* in[29]; float* out; unsigned char* ws; int ph_lo, ph_hi, use_bar, pad; };

__device__ __forceinline__ void transpose_item(const float* W, int K, int N, bf16* WT, int gu, int row_off, LAS float* scr, int item, int lane) {
    const int nblk = N / 32, kb = item / nblk, nb = item % nblk, k0 = 64 * kb, n0 = 32 * nb;
#pragma unroll 8
    for (int i = 0; i < 32; ++i) { const int kk = 2 * i + (lane >> 5); scr[kk * 33 + (lane & 31)] = W[(size_t)(k0 + kk) * N + n0 + (lane & 31)]; }
    LDS_WAIT(); asm volatile("" ::: "memory");
    const int drow0 = gu ? (256 * (n0 >> 7) + (n0 & 127) + row_off) : (row_off + n0);
    const int c = lane & 7;
#pragma unroll
    for (int j = 0; j < 4; ++j) { const int n = (lane >> 3) + 8 * j; const LAS float* s = scr + (8 * c) * 33 + n;
        u32x4 o; o.x = pk2(s[0 * 33], s[1 * 33]); o.y = pk2(s[2 * 33], s[3 * 33]); o.z = pk2(s[4 * 33], s[5 * 33]); o.w = pk2(s[6 * 33], s[7 * 33]);
        *(GAS u32x4*)(WT + (size_t)(drow0 + n) * K + k0 + 8 * c) = o; }
    LDS_WAIT(); asm volatile("" ::: "memory");
}
__device__ __forceinline__ void norm_row(const float* xrow, const float* g, bf16* nrow, int lane) {
    const GAS f32x4* xr = (const GAS f32x4*)xrow + lane; const GAS f32x4* gr = (const GAS f32x4*)g + lane;
    f32x4 v[8]; float s = 0.f;
#pragma unroll
    for (int j = 0; j < 8; ++j) { v[j] = xr[64 * j]; s += (v[j].x * v[j].x + v[j].y * v[j].y) + (v[j].z * v[j].z + v[j].w * v[j].w); }
    const float r = 1.0f / sqrtf(wave_sum(s) * (1.0f / D) + 1e-6f);
    GAS u32x2* o8 = (GAS u32x2*)nrow + lane;
#pragma unroll
    for (int j = 0; j < 8; ++j) { const f32x4 gg = gr[64 * j]; u32x2 w; w.x = pk2(v[j].x * r * gg.x, v[j].y * r * gg.y); w.y = pk2(v[j].z * r * gg.z, v[j].w * r * gg.w); o8[64 * j] = w; }
}
__device__ __forceinline__ void thin_row(const float* hrow, const float* xs, float* xd, bf16* nrow, const float* gpost, const float* gpre, float scale, int lane) {
    const GAS f32x4* hr = (const GAS f32x4*)hrow + lane; const GAS f32x4* xr = (const GAS f32x4*)xs + lane; const GAS f32x4* gp = (const GAS f32x4*)gpost + lane;
    f32x4 h[8]; float s = 0.f;
#pragma unroll
    for (int j = 0; j < 8; ++j) { h[j] = hr[64 * j]; s += (h[j].x * h[j].x + h[j].y * h[j].y) + (h[j].z * h[j].z + h[j].w * h[j].w); }
    const float rh = scale / sqrtf(wave_sum(s) * (1.0f / D) + 1e-6f);
    GAS f32x4* xo = (GAS f32x4*)xd + lane; float s2 = 0.f;
#pragma unroll
    for (int j = 0; j < 8; ++j) { const f32x4 x = xr[64 * j], g = gp[64 * j]; f32x4 y; y.x = x.x + rh * h[j].x * g.x; y.y = x.y + rh * h[j].y * g.y; y.z = x.z + rh * h[j].z * g.z; y.w = x.w + rh * h[j].w * g.w;
        h[j] = y; xo[64 * j] = y; s2 += (y.x * y.x + y.y * y.y) + (y.z * y.z + y.w * y.w); }
    if (gpre) {
        const float r = 1.0f / sqrtf(wave_sum(s2) * (1.0f / D) + 1e-6f);
        const GAS f32x4* gq = (const GAS f32x4*)gpre + lane; GAS u32x2* o8 = (GAS u32x2*)nrow + lane;
#pragma unroll
        for (int j = 0; j < 8; ++j) { const f32x4 gg = gq[64 * j]; u32x2 w; w.x = pk2(h[j].x * r * gg.x, h[j].y * r * gg.y); w.y = pk2(h[j].z * r * gg.z, h[j].w * r * gg.w); o8[64 * j] = w; }
    }
}
__device__ __forceinline__ void hid_item(const Args& a, int l, int t, float* HID, int lane) {
    float z = 0.f;
    if (lane == 0) z = (float)t / 4095.0f;
    else if (lane <= 32) { const int jj = (lane - 1) & 15; const double f = 1e-4 + (double)jj * ((15.0 - 1e-4) / 15.0); double rev = f * (double)t / 4096.0; rev -= floor(rev);
        const float rv = (float)rev; z = (lane <= 16) ? __builtin_amdgcn_cosf(rv) : -__builtin_amdgcn_sinf(rv); }
    const float* w1 = a.in[10] + (size_t)l * 33 * 64; const float* fb = a.in[11] + (size_t)l * 3 * 64; const float* fq = a.in[12] + (size_t)l * 3 * 64; const float* wi = a.in[13] + (size_t)l * 2 * 64 * 64;
    float acc = 0.f;
#pragma unroll 1
    for (int i = 0; i < 33; ++i) acc += __shfl(z, i) * w1[i * 64 + lane];
    float h = sin_rad(fq[lane] * (acc + fb[lane]));
#pragma unroll 1
    for (int q = 0; q < 2; ++q) { acc = 0.f;
#pragma unroll 4
        for (int i = 0; i < 64; ++i) acc += __shfl(h, i) * wi[(q * 64 + i) * 64 + lane];
        h = sin_rad(fq[(q + 1) * 64 + lane] * (acc + fb[(q + 1) * 64 + lane])); }
    HID[((size_t)l * 4096 + t) * 64 + lane] = h;
}
__device__ __forceinline__ void taps_tile(const Args& a, int l, int tile, const float* HID, float* TAPS, LAS unsigned char* lds, int tid) {
    LAS float* Hs = (LAS float*)lds; LAS float* Ws = (LAS float*)(lds + 64 * 65 * 4);
    const int t0 = (tile & 63) * 64, c0 = (tile >> 6) * 64;
    const float* wo = a.in[14] + (size_t)l * 64 * 4096;
#pragma unroll
    for (int i = 0; i < 8; ++i) { const int idx = tid + 512 * i, r = idx >> 6, j = idx & 63; Hs[r * 65 + j] = HID[((size_t)l * 4096 + t0 + r) * 64 + j]; Ws[r * 64 + j] = wo[(size_t)r * 4096 + c0 + j]; }
    __syncthreads();
    const int tt = tid & 63, cg = tid >> 6;
    float acc[8];
#pragma unroll
    for (int i = 0; i < 8; ++i) acc[i] = 0.f;
#pragma unroll 4
    for (int j = 0; j < 64; ++j) { const float h = Hs[tt * 65 + j]; const f32x4 w0 = *(const LAS f32x4*)(Ws + j * 64 + cg * 8), w1 = *(const LAS f32x4*)(Ws + j * 64 + cg * 8 + 4);
        acc[0] += h * w0.x; acc[1] += h * w0.y; acc[2] += h * w0.z; acc[3] += h * w0.w; acc[4] += h * w1.x; acc[5] += h * w1.y; acc[6] += h * w1.z; acc[7] += h * w1.w; }
    const float tn = (float)(t0 + tt) * (1.0f / 4095.0f);
    const float dmin = -3.0701134573253944f, dmax = -15.350567286626972f;
#pragma unroll
    for (int i = 0; i < 8; ++i) { const int col = c0 + cg * 8 + i, c = col & 1023; const float dl = fabsf(dmin + (float)c * ((dmax - dmin) / 1023.0f));
        TAPS[(size_t)col * 4096 + t0 + tt] = acc[i] * __expf(-tn * dl); }
    __syncthreads();
}
template <int E> __device__ __forceinline__ float sconv(const bf16* rb, int tid, float w0, float w1, float w2, float bias) {
    float pv = bf2f(rb[tid]), cv = bf2f(rb[tid + 1]), nv = bf2f(rb[tid + 2]);
    if (E == 0) pv = (tid == 0) ? 0.f : pv;
    if (E == 7) nv = (tid == 511) ? 0.f : nv;
    return bias + w0 * pv + w1 * cv + w2 * nv;
}
constexpr int HY_X_BYTES = FFT_SLOTS * 8, HY_Y1_OFF = HY_X_BYTES;
template <int E> __device__ __forceinline__ void hy_in(cf (&v)[16], int o, int p, const bf16* Rv, const LAS float* Y1, int tid, float w0, float w1, float w2, float bias) {
    float u0, u1;
    if (o == 0) { u0 = sconv<E>(Rv + (2 * p) * SEQ + 512 * E - 1, tid, w0, w1, w2, bias); u1 = sconv<E>(Rv + (2 * p + 1) * SEQ + 512 * E - 1, tid, w0, w1, w2, bias); }
    else { u0 = Y1[((2 * p) * 8 + E) * 512 + tid]; u1 = Y1[((2 * p + 1) * 8 + E) * 512 + tid]; }
    v[E] = cf{u0, u1}; v[E + 8] = cf{0.f, 0.f};
}
template <int E> __device__ __forceinline__ void hy_out(const cf (&v)[16], int o, int p, const bf16* Rv, const bf16* Rx, LAS float* Y1, bf16* AOc, int tid, float w0, float w1, float w2, float bias, float x0, float x1, float x2, float xb, float skip) {
    float u0, u1;
    if (o == 0) { u0 = sconv<E>(Rv + (2 * p) * SEQ + 512 * E - 1, tid, w0, w1, w2, bias); u1 = sconv<E>(Rv + (2 * p + 1) * SEQ + 512 * E - 1, tid, w0, w1, w2, bias); }
    else { u0 = Y1[((2 * p) * 8 + E) * 512 + tid]; u1 = Y1[((2 * p + 1) * 8 + E) * 512 + tid]; }
    const float r0 = sconv<E>(Rx + (2 * p) * SEQ + 512 * E - 1, tid, x0, x1, x2, xb) * (v[E].x * (1.0f / 8192.0f) + u0 * skip);
    const float r1 = sconv<E>(Rx + (2 * p + 1) * SEQ + 512 * E - 1, tid, x0, x1, x2, xb) * (v[E].y * (1.0f / 8192.0f) + u1 * skip);
    if (o == 0) { Y1[((2 * p) * 8 + E) * 512 + tid] = r0; Y1[((2 * p + 1) * 8 + E) * 512 + tid] = r1; }
    else { bf16* o0 = AOc + (size_t)((2 * p) * SEQ + 512 * E) * DH; bf16* o1 = AOc + (size_t)((2 * p + 1) * SEQ + 512 * E) * DH; o0[tid * DH] = (bf16)f2bf(r0); o1[tid * DH] = (bf16)f2bf(r1); }
}
__device__ __forceinline__ void hyena_task(const Args& a, int l, int c, const bf16* PT, const float* TAPS, bf16* AO, LAS unsigned char* lds, int tid) {
    LAS f32x2v* X = (LAS f32x2v*)lds;
    LAS float* Y1 = (LAS float*)(lds + HY_Y1_OFF);
    const float* cw = a.in[8] + (size_t)l * 3 * NHY; const float* cb = a.in[9] + (size_t)l * NHY;
    const bf16* Rv = PT + (size_t)c * M;
    const float wv0 = cw[c], wv1 = cw[NHY + c], wv2 = cw[2 * NHY + c], bv = cb[c];
    cf Kr[2][8];
#pragma unroll 1
    for (int o = 0; o < 2; ++o) {
        const int cx = (o == 0 ? 1024 : 2048) + c;
        const float wx0 = cw[cx], wx1 = cw[NHY + cx], wx2 = cw[2 * NHY + cx], bx = cb[cx];
        const bf16* Rx = PT + (size_t)cx * M;
        const float skip = a.in[15][((size_t)l * 2 + o) * DH + c];
        {
            const float* tf = TAPS + (size_t)(o * 2048 + c) * 4096; const float* tb = TAPS + (size_t)(o * 2048 + 1024 + c) * 4096;
            const int ntid = 512 - tid;
            cf v[16];
#pragma unroll
            for (int e = 0; e < 8; ++e) v[e] = cf{(tf + 512 * e)[tid], 0.f};
#pragma unroll
            for (int e = 8; e < 16; ++e) { const float tv = (tb + 3584 - 512 * (e - 8))[ntid]; v[e] = cf{(e == 8 && tid == 0) ? 0.f : tv, 0.f}; }
            pass1_fwd_store(X, tid, v); __syncthreads();
            pass_lds<4, 3, false>(X, tid); __syncthreads();
            pass_lds<7, 3, false>(X, tid); __syncthreads();
            pass4<true>(X, tid, Kr); __syncthreads();
        }
#pragma unroll 1
        for (int p = 0; p < 2; ++p) {
            cf v[16];
            hy_in<0>(v, o, p, Rv, Y1, tid, wv0, wv1, wv2, bv); hy_in<1>(v, o, p, Rv, Y1, tid, wv0, wv1, wv2, bv); hy_in<2>(v, o, p, Rv, Y1, tid, wv0, wv1, wv2, bv); hy_in<3>(v, o, p, Rv, Y1, tid, wv0, wv1, wv2, bv);
            hy_in<4>(v, o, p, Rv, Y1, tid, wv0, wv1, wv2, bv); hy_in<5>(v, o, p, Rv, Y1, tid, wv0, wv1, wv2, bv); hy_in<6>(v, o, p, Rv, Y1, tid, wv0, wv1, wv2, bv); hy_in<7>(v, o, p, Rv, Y1, tid, wv0, wv1, wv2, bv);
            pass1_fwd_store(X, tid, v); __syncthreads();
            pass_lds<4, 3, false>(X, tid); __syncthreads();
            pass_lds<7, 3, false>(X, tid); __syncthreads();
            pass4<false>(X, tid, Kr); __syncthreads();
            pass_lds<7, 3, true>(X, tid); __syncthreads();
            pass_lds<4, 3, true>(X, tid); __syncthreads();
            pass1_inv_load(X, tid, v);
            bf16* AOc = AO + c;
            hy_out<0>(v, o, p, Rv, Rx, Y1, AOc, tid, wv0, wv1, wv2, bv, wx0, wx1, wx2, bx, skip); hy_out<1>(v, o, p, Rv, Rx, Y1, AOc, tid, wv0, wv1, wv2, bv, wx0, wx1, wx2, bx, skip);
            hy_out<2>(v, o, p, Rv, Rx, Y1, AOc, tid, wv0, wv1, wv2, bv, wx0, wx1, wx2, bx, skip); hy_out<3>(v, o, p, Rv, Rx, Y1, AOc, tid, wv0, wv1, wv2, bv, wx0, wx1, wx2, bx, skip);
            hy_out<4>(v, o, p, Rv, Rx, Y1, AOc, tid, wv0, wv1, wv2, bv, wx0, wx1, wx2, bx, skip); hy_out<5>(v, o, p, Rv, Rx, Y1, AOc, tid, wv0, wv1, wv2, bv, wx0, wx1, wx2, bx, skip);
            hy_out<6>(v, o, p, Rv, Rx, Y1, AOc, tid, wv0, wv1, wv2, bv, wx0, wx1, wx2, bx, skip); hy_out<7>(v, o, p, Rv, Rx, Y1, AOc, tid, wv0, wv1, wv2, bv, wx0, wx1, wx2, bx, skip);
            __syncthreads();
        }
    }
}
__device__ __forceinline__ void sgu_task(const Args& a, int l, int task, const bf16* ZZ, bf16* BO, LAS unsigned char* lds, int tid, int wave, int lane) {
    const int g = task & 7, m0 = (task >> 3) * 128;
    LAS float* stats = (LAS float*)lds;
    LAS bf16* Wl = (LAS bf16*)(lds + 1024);
    LAS bf16* Vt = (LAS bf16*)(lds + 1024 + 128 * 272);
    const float* lng = a.in[16] + (size_t)l * DG; const float* lnb = a.in[17] + (size_t)l * DG;
    const float* ws = a.in[18] + ((size_t)l * 8 + g) * 128 * 128; const float* bs = a.in[19] + ((size_t)l * 8 + g) * 128;
#pragma unroll 1
    for (int i = 0; i < 16; ++i) { const int tok = wave * 16 + i; const u32x4* rp = (const u32x4*)(ZZ + (size_t)(m0 + tok) * 2048 + 1024 + lane * 16);
        const u32x4 q0 = rp[0], q1 = rp[1]; float x[16];
        x[0] = pg8::bf_lo(q0.x); x[1] = pg8::bf_hi(q0.x); x[2] = pg8::bf_lo(q0.y); x[3] = pg8::bf_hi(q0.y); x[4] = pg8::bf_lo(q0.z); x[5] = pg8::bf_hi(q0.z); x[6] = pg8::bf_lo(q0.w); x[7] = pg8::bf_hi(q0.w);
        x[8] = pg8::bf_lo(q1.x); x[9] = pg8::bf_hi(q1.x); x[10] = pg8::bf_lo(q1.y); x[11] = pg8::bf_hi(q1.y); x[12] = pg8::bf_lo(q1.z); x[13] = pg8::bf_hi(q1.z); x[14] = pg8::bf_lo(q1.w); x[15] = pg8::bf_hi(q1.w);
        float s = 0.f;
#pragma unroll
        for (int k = 0; k < 16; ++k) s += x[k];
        const float mean = wave_sum(s) * (1.0f / 1024.0f); float q = 0.f;
#pragma unroll
        for (int k = 0; k < 16; ++k) { const float dd = x[k] - mean; q += dd * dd; }
        const float rstd = 1.0f / sqrtf(wave_sum(q) * (1.0f / 1024.0f) + 1e-5f);
        if (lane == 0) { stats[tok * 2] = mean; stats[tok * 2 + 1] = rstd; } }
#pragma unroll
    for (int i = 0; i < 8; ++i) { const int e4 = tid + 512 * i, r = e4 >> 5, c4 = e4 & 31; const f32x4 w = *(const f32x4*)(ws + r * 128 + c4 * 4);
        u32x2 o; o.x = pk2(w.x, w.y); o.y = pk2(w.z, w.w); *(LAS u32x2*)(Wl + r * 136 + c4 * 4) = o; }
    __syncthreads();
#pragma unroll
    for (int i = 0; i < 4; ++i) { const int q = tid + 512 * i, s = q >> 4, dc = q & 15; const u32x4 raw = *(const u32x4*)(ZZ + (size_t)(m0 + s) * 2048 + 1024 + g * 128 + dc * 8);
        const float mean = stats[s * 2], rstd = stats[s * 2 + 1]; const float* gg = lng + g * 128 + dc * 8; const float* bb = lnb + g * 128 + dc * 8;
        float x[8]; x[0] = pg8::bf_lo(raw.x); x[1] = pg8::bf_hi(raw.x); x[2] = pg8::bf_lo(raw.y); x[3] = pg8::bf_hi(raw.y); x[4] = pg8::bf_lo(raw.z); x[5] = pg8::bf_hi(raw.z); x[6] = pg8::bf_lo(raw.w); x[7] = pg8::bf_hi(raw.w);
#pragma unroll
        for (int k = 0; k < 8; ++k) Vt[(dc * 8 + k) * 136 + s] = (bf16)f2bf((x[k] - mean) * rstd * gg[k] + bb[k]); }
    __syncthreads();
    const int fr = lane & 15, fq = lane >> 4;
    f32x4 acc[8];
#pragma unroll
    for (int nb = 0; nb < 8; ++nb) acc[nb] = (f32x4){0.f, 0.f, 0.f, 0.f};
#pragma unroll
    for (int kk = 0; kk < 4; ++kk) { const bf16x8 af = *(const LAS bf16x8*)(Wl + (wave * 16 + fr) * 136 + kk * 32 + fq * 8);
#pragma unroll
        for (int nb = 0; nb < 8; ++nb) { const bf16x8 bfr = *(const LAS bf16x8*)(Vt + (nb * 16 + fr) * 136 + kk * 32 + fq * 8);
            acc[nb] = __builtin_amdgcn_mfma_f32_16x16x32_bf16(bfr, af, acc[nb], 0, 0, 0); } }
    const int t = wave * 16 + fr; const float bias = bs[t];
#pragma unroll
    for (int nb = 0; nb < 8; ++nb) { const int dcol = g * 128 + nb * 16 + fq * 4; const u32x2 uq = *(const u32x2*)(ZZ + (size_t)(m0 + t) * 2048 + dcol);
        u32x2 o; o.x = pk2(pg8::bf_lo(uq.x) * (acc[nb][0] + bias), pg8::bf_hi(uq.x) * (acc[nb][1] + bias)); o.y = pk2(pg8::bf_lo(uq.y) * (acc[nb][2] + bias), pg8::bf_hi(uq.y) * (acc[nb][3] + bias));
        *(u32x2*)(BO + (size_t)(m0 + t) * DG + dcol) = o; }
    __syncthreads();
}

#define PG8_ALIGN true
#define PG8_SP2 true
#ifndef PH_MASK
#define PH_MASK 0xFFF
#endif
#ifndef HY_ON
#define HY_ON 1
#endif
#ifndef SG_ON
#define SG_ON 1
#endif
#define PH_ON(k) (((PH_MASK) >> (k)) & 1)
__global__ void __launch_bounds__(NWAVES * 64, 2) mega_fwd(Args a) {
    extern __shared__ __attribute__((aligned(16))) unsigned char lds_raw[];
    LAS unsigned char* lds = (LAS unsigned char*)lds_raw;
    volatile LAS unsigned* MISC = (volatile LAS unsigned*)(lds + MISC_OFF);
    const int tid0 = threadIdx.x, wave = __builtin_amdgcn_readfirstlane(tid0 >> 6);
#define OPAQUE_TID() int tid = tid0; asm volatile("" : "+v"(tid)); const int lane = tid & 63
    const int G = gridDim.x, bid = blockIdx.x;
    const int gw = bid * NWAVES + wave, NGW = G * NWAVES;
    unsigned char* ws = a.ws;
    if (tid0 < 16) MISC[tid0] = 0u;
    __syncthreads();
    XcdBarrier bar; bar.bar = (unsigned*)(ws + WS_CTL) + CW_BAR; bar.x = 0; bar.st = nullptr;
    if (a.use_bar) bar = xcd_barrier_post((unsigned*)(ws + WS_CTL) + CW_BAR, MISC + 8);
    const int lo = a.ph_lo, hi = a.ph_hi;
#define IN(k) (lo <= (k) && (k) < hi)
#define SEAM(k) do { if (IN((k) + 1)) xcd_barrier(bar); } while (0)

    bf16* const Wb = (bf16*)(ws + WS_W);
    float* const HID = (float*)(ws + WS_HID);
    bf16* const NB = (bf16*)(ws + WS_NB); bf16* const HB = (bf16*)(ws + WS_HB); bf16* const PT = (bf16*)(ws + WS_PT); bf16* const ZZ = (bf16*)(ws + WS_ZZ);
    float* const HD = (float*)(ws + WS_HD); bf16* const GT = (bf16*)(ws + WS_GT); bf16* const AO = (bf16*)(ws + WS_A); bf16* const BO = (bf16*)(ws + WS_B);
    bf16* const MG = (bf16*)(ws + WS_MG); float* const TAPS = (float*)(ws + WS_TAPS);
    float* const XO = a.out;

    if (PH_ON(11) && IN(0)) {
        OPAQUE_TID();
        LAS float* scr = (LAS float*)(lds + wave * 16384);
        constexpr int PER_LAYER = 47104;
#pragma unroll 1
        for (int it = gw; it < DEPTH * PER_LAYER; it += NGW) {
            const int l = it / PER_LAYER; int r = it % PER_LAYER;
            const float* src; int K, N, gu = 0, ro = 0; size_t off;
            if (r < 5632) { src = a.in[2] + (size_t)l * D * FF; K = D; N = FF; off = OFF_GU1; gu = 1; ro = 0; }
            else if ((r -= 5632) < 5632) { src = a.in[3] + (size_t)l * D * FF; K = D; N = FF; off = OFF_GU1; gu = 1; ro = 128; }
            else if ((r -= 5632) < 5632) { src = a.in[4] + (size_t)l * FF * D; K = FF; N = D; off = OFF_D1; }
            else if ((r -= 5632) < 9216) { src = a.in[7] + (size_t)l * D * DPROJ; K = D; N = DPROJ; off = OFF_WIN; }
            else if ((r -= 9216) < 1024) { src = a.in[20] + (size_t)l * DH * D; K = DH; N = D; off = OFF_PA; }
            else if ((r -= 1024) < 1024) { src = a.in[21] + (size_t)l * DG * D; K = DG; N = D; off = OFF_PB; }
            else if ((r -= 1024) < 2048) { src = a.in[22] + (size_t)l * D * D; K = D; N = D; off = OFF_WO; }
            else if ((r -= 2048) < 5632) { src = a.in[25] + (size_t)l * D * FF; K = D; N = FF; off = OFF_GU2; gu = 1; ro = 0; }
            else if ((r -= 5632) < 5632) { src = a.in[26] + (size_t)l * D * FF; K = D; N = FF; off = OFF_GU2; gu = 1; ro = 128; }
            else { r -= 5632; src = a.in[27] + (size_t)l * FF * D; K = FF; N = D; off = OFF_D2; }
            transpose_item(src, K, N, Wb + (size_t)l * LAYER_W + off, gu, ro, scr, r, lane);
        }
#pragma unroll 1
        for (int it = gw; it < DEPTH * SEQ; it += NGW) hid_item(a, it >> 12, it & 4095, HID, lane);
#pragma unroll 1
        for (int m = gw; m < M; m += NGW) norm_row(a.in[0] + (size_t)m * D, a.in[1], NB + (size_t)m * D, lane);
        SEAM(0);
    }

#pragma unroll 1
    for (int l = 0; l < DEPTH; ++l) {
        const int pb = 1 + 11 * l;
        const bf16* Wl = Wb + (size_t)l * LAYER_W;
        if (PH_ON(0) && IN(pb + 0)) {
            pg8::Gemm g{NB, Wl + OFF_GU1, M, 2 * FF, D}; pg8::StaticOrder S; S.init(M, 2 * FF, G, bid);
            pg8::EpiSwiGLU E{HB, FF};
            pg8::gemm_phase<pg8::EpiSwiGLU, pg8::StaticOrder, PG8_ALIGN, PG8_SP2>(lds, g, S, E);
            SEAM(pb + 0);
        }
        if (PH_ON(1) && IN(pb + 1)) {
            pg8::Gemm g{HB, Wl + OFF_D1, M, D, FF}; pg8::StaticOrder S; S.init(M, D, G, bid);
            pg8::EpiF32 E{HD, D};
            pg8::gemm_phase<pg8::EpiF32, pg8::StaticOrder, PG8_ALIGN, PG8_SP2>(lds, g, S, E);
            SEAM(pb + 1);
        }
        if (PH_ON(2) && IN(pb + 2)) { OPAQUE_TID();
            const float* xs = (l == 0) ? a.in[0] : XO;
#pragma unroll 1
            for (int m = gw; m < M; m += NGW) thin_row(HD + (size_t)m * D, xs + (size_t)m * D, XO + (size_t)m * D, NB + (size_t)m * D, a.in[5] + (size_t)l * D, a.in[6] + (size_t)l * D, 0.5f, lane);
#pragma unroll 1
            for (int tile = bid; tile < 4096; tile += G) taps_tile(a, l, tile, HID, TAPS, lds, tid);
            SEAM(pb + 2);
        }
        if (PH_ON(3) && IN(pb + 3)) {
            { pg8::Gemm g{Wl + OFF_WIN, NB, NHY, M, D}; pg8::StaticOrder S; S.init(NHY, M, G, bid);
              pg8::EpiBf16 E{PT, M};
              pg8::gemm_phase<pg8::EpiBf16, pg8::StaticOrder, PG8_ALIGN, PG8_SP2>(lds, g, S, E); }
            { pg8::Gemm g{NB, Wl + OFF_WIN + (size_t)NHY * D, M, DPROJ - NHY, D}; pg8::StaticOrder S; S.init(M, DPROJ - NHY, G, bid);
              pg8::EpiWinRest E{ZZ, GT};
              pg8::gemm_phase<pg8::EpiWinRest, pg8::StaticOrder, PG8_ALIGN, PG8_SP2>(lds, g, S, E); }
            SEAM(pb + 3);
        }
        if (PH_ON(4) && IN(pb + 4)) { OPAQUE_TID();
            if (HY_ON) {
#pragma unroll 1
                for (int c = bid; c < DH; c += G) hyena_task(a, l, c, PT, TAPS, AO, lds, tid); }
            if (SG_ON) {
#pragma unroll 1
                for (int task = bid; task < 1024; task += G) sgu_task(a, l, task, ZZ, BO, lds, tid, wave, lane); }
            SEAM(pb + 4);
        }
        if (PH_ON(5) && IN(pb + 5)) {
            { pg8::Gemm g{AO, Wl + OFF_PA, M, D, DH}; pg8::StaticOrder S; S.init(M, D, G, bid);
              pg8::EpiPA E{HD, GT};
              pg8::gemm_phase<pg8::EpiPA, pg8::StaticOrder, PG8_ALIGN, PG8_SP2>(lds, g, S, E); }
            { pg8::Gemm g{BO, Wl + OFF_PB, M, D, DG}; pg8::StaticOrder S; S.init(M, D, G, bid);
              pg8::EpiPB E{HD, GT, MG};
              pg8::gemm_phase<pg8::EpiPB, pg8::StaticOrder, PG8_ALIGN, PG8_SP2>(lds, g, S, E); }
            SEAM(pb + 5);
        }
        if (PH_ON(6) && IN(pb + 6)) {
            pg8::Gemm g{MG, Wl + OFF_WO, M, D, D}; pg8::StaticOrder S; S.init(M, D, G, bid);
            pg8::EpiF32 E{HD, D};
            pg8::gemm_phase<pg8::EpiF32, pg8::StaticOrder, PG8_ALIGN, PG8_SP2>(lds, g, S, E);
            SEAM(pb + 6);
        }
        if (PH_ON(7) && IN(pb + 7)) { OPAQUE_TID();
#pragma unroll 1
            for (int m = gw; m < M; m += NGW) thin_row(HD + (size_t)m * D, XO + (size_t)m * D, XO + (size_t)m * D, NB + (size_t)m * D, a.in[23] + (size_t)l * D, a.in[24] + (size_t)l * D, 1.0f, lane);
            SEAM(pb + 7);
        }
        if (PH_ON(8) && IN(pb + 8)) {
            pg8::Gemm g{NB, Wl + OFF_GU2, M, 2 * FF, D}; pg8::StaticOrder S; S.init(M, 2 * FF, G, bid);
            pg8::EpiSwiGLU E{HB, FF};
            pg8::gemm_phase<pg8::EpiSwiGLU, pg8::StaticOrder, PG8_ALIGN, PG8_SP2>(lds, g, S, E);
            SEAM(pb + 8);
        }
        if (PH_ON(9) && IN(pb + 9)) {
            pg8::Gemm g{HB, Wl + OFF_D2, M, D, FF}; pg8::StaticOrder S; S.init(M, D, G, bid);
            pg8::EpiF32 E{HD, D};
            pg8::gemm_phase<pg8::EpiF32, pg8::StaticOrder, PG8_ALIGN, PG8_SP2>(lds, g, S, E);
            SEAM(pb + 9);
        }
        if (PH_ON(10) && IN(pb + 10)) { OPAQUE_TID();
            const float* gpre = (l + 1 < DEPTH) ? a.in[1] + (size_t)(l + 1) * D : nullptr;
#pragma unroll 1
            for (int m = gw; m < M; m += NGW) thin_row(HD + (size_t)m * D, XO + (size_t)m * D, XO + (size_t)m * D, NB + (size_t)m * D, a.in[28] + (size_t)l * D, gpre, 0.5f, lane);
            SEAM(pb + 10);
        }
    }
#undef IN
#undef SEAM
}

extern "C" void kernel_launch(void* const* d_in, const int* in_sizes, int n_in, void* d_out, int out_size, void* d_ws, size_t ws_size, hipStream_t stream) {
    static int grid = 0;
    if (grid == 0) {
        if (n_in != 29 || out_size != M * D || ws_size < WS_END) { fprintf(stderr, "kernel_launch: unexpected shapes (n_in %d out %d ws %zu)\n", n_in, out_size, ws_size); grid = -1; return; }
        int dev = 0, cus = 0, per_cu = 0;
        if (hipGetDevice(&dev) != hipSuccess || hipDeviceGetAttribute(&cus, hipDeviceAttributeMultiprocessorCount, dev) != hipSuccess) { grid = -1; return; }
        if (hipFuncSetAttribute((const void*)mega_fwd, hipFuncAttributeMaxDynamicSharedMemorySize, LDS_BYTES) != hipSuccess) { fprintf(stderr, "kernel_launch: hipFuncSetAttribute failed\n"); grid = -1; return; }
        if (hipOccupancyMaxActiveBlocksPerMultiprocessor(&per_cu, (const void*)mega_fwd, NWAVES * 64, LDS_BYTES) != hipSuccess || per_cu < 1) { fprintf(stderr, "kernel_launch: occupancy query says %d\n", per_cu); }
        (void)hipGetLastError();
        grid = cus;
    }
    if (grid < 0) return;
    (void)hipMemsetAsync((char*)d_ws + WS_CTL, 0, CTL_ZERO_BYTES, stream);
    Args a{};
    for (int i = 0; i < 29; ++i) a.in[i] = (const float*)d_in[i];
    a.out = (float*)d_out; a.ws = (unsigned char*)d_ws; a.pad = 0;
#if MK_SINGLE
    a.ph_lo = 0; a.ph_hi = NPH; a.use_bar = 1;
    hipLaunchKernelGGL(mega_fwd, dim3(grid), dim3(NWAVES * 64), LDS_BYTES, stream, a);
#else
    for (int p = 0; p < NPH; ++p) { a.ph_lo = p; a.ph_hi = p + 1; a.use_bar = 0;
        hipLaunchKernelGGL(mega_fwd, dim3(grid), dim3(NWAVES * 64), LDS_BYTES, stream, a); }
#endif
}
```
